# Optimizing an MI355X kernel written in HIP

```python
import math
import jax, jax.numpy as jnp
from jax import lax
import numpy as np

D_MODEL = 1024
BATCH = 4
SEQ = 4096
DEPTH = 4

N_A_LAYERS = DEPTH // 2
N_B_LAYERS = DEPTH - N_A_LAYERS
CHUNK = 128
SGU_WIDTH = 2 * D_MODEL
SGU_GROUPS = 8
HEAD_DIM = 64
KV_HEADS = D_MODEL // 128
DILATED_GROUPS = ((128, 1), (512, 4), (2048, 16))
N_GROUPS = len(DILATED_GROUPS)
Q_HEADS = N_GROUPS * KV_HEADS
BLK = 128
REL_BUCKETS = 32
REL_MAX_DIST = 2048
D_FF = 2816
CONV_WIDTH = 3
ALPHA = (2 * DEPTH) ** 0.25
BETA = (8 * DEPTH) ** -0.25
LN_EPS = 1e-5
NEG = -1e30

kernel_name = 'hybrid_sgu_dilated_yoco'


def layer_norm(x, g, b):
    xf = x.astype(jnp.float32)
    mu = jnp.mean(xf, axis=-1, keepdims=True)
    var = jnp.mean(jnp.square(xf - mu), axis=-1, keepdims=True)
    y = (xf - mu) * lax.rsqrt(var + LN_EPS) * g.astype(jnp.float32) + b.astype(jnp.float32)
    return y.astype(x.dtype)


def conv_ffn(x, w_up, conv_w, conv_b, w_down):
    T = x.shape[1]
    h = x @ w_up
    hp = jnp.pad(h, ((0, 0), (CONV_WIDTH - 1, 0), (0, 0)))
    h = sum(hp[:, k:k + T] * conv_w[k] for k in range(CONV_WIDTH)) + conv_b
    a, g = jnp.split(h, 2, axis=-1)
    return (jax.nn.gelu(a, approximate=False) * g) @ w_down


def mixer_a(x, w_in, ln_g, ln_b, w_s, b_s, w_out):
    B, T, _ = x.shape
    z = jax.nn.gelu(x @ w_in, approximate=False)
    u, v = jnp.split(z, 2, axis=-1)
    v = layer_norm(v, ln_g, ln_b)
    v = v.reshape(B, T // CHUNK, CHUNK, SGU_GROUPS, SGU_WIDTH // SGU_GROUPS)
    ws = w_s * jnp.tril(jnp.ones((CHUNK, CHUNK), w_s.dtype))
    sv = jnp.einsum('gts,bnsgc->bntgc', ws, v) + b_s.T[None, None, :, :, None]
    y = u * sv.reshape(B, T, SGU_WIDTH)
    return y @ w_out


def t5_bucket(dist):
    n = dist.astype(jnp.int32)
    max_exact = REL_BUCKETS // 2
    nf = jnp.maximum(n, 1).astype(jnp.float32)
    large = max_exact + (jnp.log(nf / max_exact) / math.log(REL_MAX_DIST / max_exact)
                         * (REL_BUCKETS - max_exact)).astype(jnp.int32)
    large = jnp.minimum(large, REL_BUCKETS - 1)
    return jnp.where(n < max_exact, n, large)


def band_delta():
    iq = jnp.arange(BLK)[:, None]
    ik = jnp.arange(2 * BLK)[None, :]
    return iq + BLK - ik


def band_bias(table_g, dil):
    dist = jnp.clip(band_delta(), 0, None) * dil
    return jnp.transpose(table_g[t5_bucket(dist)], (2, 0, 1)).astype(jnp.float32)


def dilated_band_attention(q, k, v, dil, n_back, bias):
    B, T, H, Dh = q.shape
    span = dil * BLK
    Tp = -(-T // span) * span
    S = Tp // dil
    NB = S // BLK

    def to_blocks(a):
        a = jnp.pad(a, ((0, 0), (0, Tp - T), (0, 0), (0, 0)))
        a = a.reshape(B, S, dil, H, Dh).transpose(0, 2, 3, 1, 4)
        return a.reshape(B, dil, H, NB, BLK, Dh)

    def band(a):
        prev = jnp.pad(a[:, :, :, :-1], ((0, 0), (0, 0), (0, 0), (1, 0), (0, 0), (0, 0)))
        return jnp.concatenate([prev, a], axis=4)

    qb, kb, vb = to_blocks(q), band(to_blocks(k)), band(to_blocks(v))
    s = jnp.einsum('brhnqd,brhnkd->brhnqk', qb, kb).astype(jnp.float32) * (Dh ** -0.5)
    s = s + bias[:, None]
    delta = band_delta()
    valid = (delta >= 0) & (delta <= n_back)
    first = (jnp.arange(NB)[:, None, None] == 0) & (jnp.arange(2 * BLK)[None, None, :] < BLK)
    valid = valid[None] & ~first
    s = jnp.where(valid, s, NEG)
    m = jnp.max(s, axis=-1, keepdims=True)
    p = jnp.exp(s - m)
    den = jnp.sum(p, axis=-1, keepdims=True)
    o = jnp.einsum('brhnqk,brhnkd->brhnqd', (p / den).astype(v.dtype), vb)
    lse = (m + jnp.log(den))[..., 0]
    o = o.reshape(B, dil, H, S, Dh).transpose(0, 3, 1, 2, 4).reshape(B, Tp, H, Dh)[:, :T]
    lse = lse.reshape(B, dil, H, S).transpose(0, 3, 1, 2).reshape(B, Tp, H)[:, :T]
    return o, lse


def mixer_b(x, k, v, w_q, w_o, rel_table):
    B, T, _ = x.shape
    q = (x @ w_q).reshape(B, T, N_GROUPS, KV_HEADS, HEAD_DIM)
    outs, lses = [], []
    for g, (win, dil) in enumerate(DILATED_GROUPS):
        bias = band_bias(rel_table[:, g * KV_HEADS:(g + 1) * KV_HEADS], dil)
        o, lse = dilated_band_attention(q[:, :, g], k, v, dil, win // dil, bias)
        outs.append(o)
        lses.append(lse)
    wts = jax.nn.softmax(jnp.stack(lses, axis=0), axis=0)
    o = jnp.einsum('gbth,gbthd->bthd', wts, jnp.stack(outs, axis=0).astype(jnp.float32))
    return o.reshape(B, T, KV_HEADS * HEAD_DIM).astype(x.dtype) @ w_o


def setup_inputs(seed: int = 0) -> dict:
    key = jax.random.key(seed)
    ks = jax.random.split(key, 20)
    f32 = jnp.float32
    nrm = lambda k, shape, s: jax.random.normal(k, shape, f32) * s
    E2 = 2 * SGU_WIDTH
    return {
        'x': nrm(ks[0], (BATCH, SEQ, D_MODEL), 1.0),
        'a_w_in': nrm(ks[1], (N_A_LAYERS, D_MODEL, E2), D_MODEL ** -0.5),
        'a_ln_g': 1.0 + nrm(ks[2], (N_A_LAYERS, SGU_WIDTH), 0.05),
        'a_ln_b': nrm(ks[3], (N_A_LAYERS, SGU_WIDTH), 0.02),
        'a_w_s': nrm(ks[4], (N_A_LAYERS, SGU_GROUPS, CHUNK, CHUNK), CHUNK ** -0.5),
        'a_b_s': 1.0 + nrm(ks[5], (N_A_LAYERS, SGU_GROUPS, CHUNK), 0.1),
        'a_w_out': nrm(ks[6], (N_A_LAYERS, SGU_WIDTH, D_MODEL), BETA * SGU_WIDTH ** -0.5),
        'kv_w': nrm(ks[7], (D_MODEL, 2 * KV_HEADS * HEAD_DIM), D_MODEL ** -0.5),
        'b_w_q': nrm(ks[8], (N_B_LAYERS, D_MODEL, Q_HEADS * HEAD_DIM), D_MODEL ** -0.5),
        'b_w_o': nrm(ks[9], (N_B_LAYERS, KV_HEADS * HEAD_DIM, D_MODEL), BETA * (KV_HEADS * HEAD_DIM) ** -0.5),
        'rel_table': nrm(ks[10], (REL_BUCKETS, Q_HEADS), 0.5),
        'ffn_w_up': nrm(ks[11], (DEPTH, D_MODEL, 2 * D_FF), D_MODEL ** -0.5),
        'ffn_conv_w': nrm(ks[12], (DEPTH, CONV_WIDTH, 2 * D_FF), CONV_WIDTH ** -0.5),
        'ffn_conv_b': nrm(ks[13], (DEPTH, 2 * D_FF), 0.02),
        'ffn_w_down': nrm(ks[14], (DEPTH, D_FF, D_MODEL), BETA * D_FF ** -0.5),
        'ln_g': 1.0 + nrm(ks[15], (DEPTH, 2, D_MODEL), 0.05),
        'ln_b': nrm(ks[16], (DEPTH, 2, D_MODEL), 0.02),
    }


def reference(x, a_w_in, a_ln_g, a_ln_b, a_w_s, a_b_s, a_w_out, kv_w, b_w_q, b_w_o,
              rel_table, ffn_w_up, ffn_conv_w, ffn_conv_b, ffn_w_down, ln_g, ln_b):
    B, T, _ = x.shape
    k = v = None
    for i in range(DEPTH):
        if i < N_A_LAYERS:
            h = mixer_a(x, a_w_in[i], a_ln_g[i], a_ln_b[i], a_w_s[i], a_b_s[i], a_w_out[i])
        else:
            if i == N_A_LAYERS:
                kv = (x @ kv_w).reshape(B, T, 2, KV_HEADS, HEAD_DIM)
                k, v = kv[:, :, 0], kv[:, :, 1]
            j = i - N_A_LAYERS
            h = mixer_b(x, k, v, b_w_q[j], b_w_o[j], rel_table)
        x = layer_norm(ALPHA * x + h, ln_g[i, 0], ln_b[i, 0])
        f = conv_ffn(x, ffn_w_up[i], ffn_conv_w[i], ffn_conv_b[i], ffn_w_down[i])
        x = layer_norm(ALPHA * x + f, ln_g[i, 1], ln_b[i, 1])
    return x
```

```cpp
#include <hip/hip_runtime.h>
#include <cstdio>
#include <cstdint>
#include <cmath>

namespace nv {
constexpr int D = 1024, BATCH = 4, SEQ = 4096, DEPTH = 4, NA = 2;
constexpr int CHUNK = 128, E = 2048, G = 8, GC = E / G;
constexpr int HD = 64, KVH = 8, NG = 3, QH = 24, KVD = KVH * HD, QD = QH * HD;
constexpr int FF = 2816;
constexpr float LN_EPS = 1e-5f;
constexpr float ALPHA = 1.681792830507429f;

__device__ __forceinline__ float gelu_erf(float v) { return 0.5f * v * (1.0f + erff(v * 0.70710678118654752f)); }

template <int EPI>
__global__ __launch_bounds__(256) void sgemm128(const float* __restrict__ A, int lda, const float* __restrict__ B, int ldb, float* __restrict__ C, int ldc, int K) {
    __shared__ float As[16][132];
    __shared__ float Bs[16][132];
    const int tid = threadIdx.x, tx = tid & 15, ty = tid >> 4;
    const int m0 = blockIdx.y * 128, n0 = blockIdx.x * 128;
    float acc[8][8];
#pragma unroll
    for (int i = 0; i < 8; ++i)
#pragma unroll
        for (int j = 0; j < 8; ++j) acc[i][j] = 0.f;
    for (int k0 = 0; k0 < K; k0 += 16) {
#pragma unroll
        for (int p = 0; p < 2; ++p) {
            const int r = (tid >> 2) + p * 64, c = (tid & 3) * 4;
            const float4 v = *(const float4*)(A + (size_t)(m0 + r) * lda + k0 + c);
            As[c + 0][r] = v.x; As[c + 1][r] = v.y; As[c + 2][r] = v.z; As[c + 3][r] = v.w;
        }
#pragma unroll
        for (int p = 0; p < 2; ++p) {
            const int r = (tid >> 5) + p * 8, c = (tid & 31) * 4;
            const float4 v = *(const float4*)(B + (size_t)(k0 + r) * ldb + n0 + c);
            *(float4*)&Bs[r][c] = v;
        }
        __syncthreads();
#pragma unroll
        for (int kk = 0; kk < 16; ++kk) {
            float a[8], b[8];
            const float4 a0 = *(const float4*)&As[kk][ty * 4], a1 = *(const float4*)&As[kk][64 + ty * 4];
            const float4 b0 = *(const float4*)&Bs[kk][tx * 4], b1 = *(const float4*)&Bs[kk][64 + tx * 4];
            a[0] = a0.x; a[1] = a0.y; a[2] = a0.z; a[3] = a0.w; a[4] = a1.x; a[5] = a1.y; a[6] = a1.z; a[7] = a1.w;
            b[0] = b0.x; b[1] = b0.y; b[2] = b0.z; b[3] = b0.w; b[4] = b1.x; b[5] = b1.y; b[6] = b1.z; b[7] = b1.w;
#pragma unroll
            for (int i = 0; i < 8; ++i)
#pragma unroll
                for (int j = 0; j < 8; ++j) acc[i][j] = fmaf(a[i], b[j], acc[i][j]);
        }
        __syncthreads();
    }
#pragma unroll
    for (int i = 0; i < 8; ++i) {
        const int r = m0 + (i < 4 ? ty * 4 + i : 64 + ty * 4 + (i - 4));
#pragma unroll
        for (int jh = 0; jh < 2; ++jh) {
            float4 o;
            o.x = acc[i][jh * 4 + 0]; o.y = acc[i][jh * 4 + 1]; o.z = acc[i][jh * 4 + 2]; o.w = acc[i][jh * 4 + 3];
            if (EPI == 1) { o.x = gelu_erf(o.x); o.y = gelu_erf(o.y); o.z = gelu_erf(o.z); o.w = gelu_erf(o.w); }
            *(float4*)(C + (size_t)r * ldc + n0 + jh * 64 + tx * 4) = o;
        }
    }
}

__device__ __forceinline__ float block_sum256(float v, float* red) {
#pragma unroll
    for (int o = 32; o >= 1; o >>= 1) v += __shfl_xor(v, o);
    const int w = threadIdx.x >> 6;
    __syncthreads();
    if ((threadIdx.x & 63) == 0) red[w] = v;
    __syncthreads();
    return red[0] + red[1] + red[2] + red[3];
}

__global__ __launch_bounds__(256) void ln_rows(const float* a, int lda, float alpha, const float* b, int ldb, const float* g, const float* beta, float* out, int ldo, int n) {
    __shared__ float red[4];
    const int row = blockIdx.x; const int per = n / 256;
    float v[8]; float s = 0.f;
#pragma unroll
    for (int i = 0; i < 8; ++i) if (i < per) { const int c = threadIdx.x + i * 256; float t = alpha * a[(size_t)row * lda + c]; if (b) t += b[(size_t)row * ldb + c]; v[i] = t; s += t; }
    const float mean = block_sum256(s, red) / (float)n;
    float q = 0.f;
#pragma unroll
    for (int i = 0; i < 8; ++i) if (i < per) { const float d = v[i] - mean; q += d * d; }
    const float var = block_sum256(q, red) / (float)n;
    const float rstd = 1.0f / sqrtf(var + LN_EPS);
#pragma unroll
    for (int i = 0; i < 8; ++i) if (i < per) { const int c = threadIdx.x + i * 256; out[(size_t)row * ldo + c] = (v[i] - mean) * rstd * g[c] + beta[c]; }
}

__global__ __launch_bounds__(256) void sgu_naive(const float* z, const float* ws, const float* bs, float* y) {
    const int c = blockIdx.x * 256 + threadIdx.x;
    const int t = blockIdx.y;
    const int g = c / GC, tl = t % CHUNK, t0 = t - tl;
    const float* w = ws + ((size_t)g * CHUNK + tl) * CHUNK;
    float acc = 0.f;
    for (int s = 0; s <= tl; ++s) acc = fmaf(w[s], z[(size_t)(t0 + s) * (2 * E) + E + c], acc);
    acc += bs[g * CHUNK + tl];
    y[(size_t)t * E + c] = z[(size_t)t * (2 * E) + c] * acc;
}

__global__ __launch_bounds__(256) void convact_naive(const float* h, const float* cw, const float* cb, float* act) {
    const int c = blockIdx.x * 256 + threadIdx.x; const int t = blockIdx.y;
    if (c >= FF) return;
    float a = cb[c], gg = cb[FF + c];
#pragma unroll
    for (int k = 0; k < 3; ++k) { const int tt = t - 2 + k; if (tt >= 0) { a = fmaf(h[(size_t)tt * (2 * FF) + c], cw[k * 2 * FF + c], a); gg = fmaf(h[(size_t)tt * (2 * FF) + FF + c], cw[k * 2 * FF + FF + c], gg); } }
    act[(size_t)t * FF + c] = gelu_erf(a) * gg;
}

__device__ __forceinline__ int t5_bucket(int n) {
    if (n < 16) return n;
    int l = 16 + (int)(log((double)n / 16.0) / log(128.0) * 16.0);
    return l < 31 ? l : 31;
}

__global__ void bias_tab_kernel(const float* rel, float* btab) {
    const int gh = blockIdx.x, j = threadIdx.x; const int g = gh / KVH;
    const int dil = (g == 0) ? 1 : (g == 1 ? 4 : 16);
    if (j <= 128) btab[gh * 129 + j] = rel[t5_bucket(j * dil) * QH + gh];
}

__global__ __launch_bounds__(64) void attn_naive(const float* q, const float* kv, const float* btab, float* o) {
    const int t = blockIdx.x * 64 + threadIdx.x; const int h = blockIdx.y;
    float outv[64];
#pragma unroll
    for (int d = 0; d < 64; ++d) outv[d] = 0.f;
    float M = -INFINITY, L = 0.f;
    for (int g = 0; g < 3; ++g) {
        const int dil = (g == 0) ? 1 : (g == 1 ? 4 : 16);
        const float* qp = q + (size_t)t * QD + g * KVD + h * HD;
        float qr[64];
#pragma unroll
        for (int d = 0; d < 64; ++d) qr[d] = qp[d];
        const int pos = t / dil;
        const int blk0 = (pos / 128) * 128;
        for (int j = 0; j <= 128; ++j) {
            const int kpos = pos - j; if (kpos < 0) break;
            if (kpos < blk0 - 128) break;
            const int tk = t - j * dil;
            const float* kp = kv + (size_t)tk * (2 * KVD) + h * HD;
            float s = 0.f;
#pragma unroll
            for (int d = 0; d < 64; ++d) s = fmaf(qr[d], kp[d], s);
            s = s * 0.125f + btab[(g * KVH + h) * 129 + j];
            const float mn = fmaxf(M, s);
            const float sc = expf(M - mn), p = expf(s - mn);
            const float* vp = kp + KVD;
            L = L * sc + p;
#pragma unroll
            for (int d = 0; d < 64; ++d) outv[d] = fmaf(outv[d], sc, p * vp[d]);
            M = mn;
        }
    }
    const float inv = 1.0f / L;
#pragma unroll
    for (int d = 0; d < 64; ++d) o[(size_t)t * KVD + h * HD + d] = outv[d] * inv;
}
}

extern "C" void kernel_launch(void* const* d_in, const int* in_sizes, int n_in, void* d_out, int out_size, void* d_ws, size_t ws_size, hipStream_t stream) {
    using namespace nv;
    const float* x_in = (const float*)d_in[0];
    const float* a_w_in = (const float*)d_in[1];
    const float* a_ln_g = (const float*)d_in[2];
    const float* a_ln_b = (const float*)d_in[3];
    const float* a_w_s = (const float*)d_in[4];
    const float* a_b_s = (const float*)d_in[5];
    const float* a_w_out = (const float*)d_in[6];
    const float* kv_w = (const float*)d_in[7];
    const float* b_w_q = (const float*)d_in[8];
    const float* b_w_o = (const float*)d_in[9];
    const float* rel_table = (const float*)d_in[10];
    const float* ffn_w_up = (const float*)d_in[11];
    const float* ffn_conv_w = (const float*)d_in[12];
    const float* ffn_conv_b = (const float*)d_in[13];
    const float* ffn_w_down = (const float*)d_in[14];
    const float* ln_g = (const float*)d_in[15];
    const float* ln_b = (const float*)d_in[16];
    float* X = (float*)d_out;
    constexpr size_t MiB = 1u << 20;
    char* ws = (char*)d_ws;
    float* RA = (float*)(ws);
    float* Y = (float*)(ws + 88 * MiB);
    float* H = (float*)(ws + 132 * MiB);
    float* KV = (float*)(ws + 148 * MiB);
    float* O = (float*)(ws + 212 * MiB);
    float* BT = (float*)(ws + 220 * MiB);
    bias_tab_kernel<<<QH, 192, 0, stream>>>(rel_table, BT);
    (void)hipMemcpyAsync(X, x_in, (size_t)BATCH * SEQ * D * 4, hipMemcpyDeviceToDevice, stream);
    for (int i = 0; i < DEPTH; ++i) {
        for (int b = 0; b < BATCH; ++b) {
            float* xb = X + (size_t)b * SEQ * D;
            if (i < NA) {
                const float* w_in = a_w_in + (size_t)i * D * 2 * E;
                sgemm128<1><<<dim3(2 * E / 128, SEQ / 128), 256, 0, stream>>>(xb, D, w_in, 2 * E, RA, 2 * E, D);
                ln_rows<<<SEQ, 256, 0, stream>>>(RA + E, 2 * E, 1.0f, nullptr, 0, a_ln_g + i * E, a_ln_b + i * E, RA + E, 2 * E, E);
                sgu_naive<<<dim3(E / 256, SEQ), 256, 0, stream>>>(RA, a_w_s + (size_t)i * G * CHUNK * CHUNK, a_b_s + (size_t)i * G * CHUNK, Y);
                sgemm128<0><<<dim3(D / 128, SEQ / 128), 256, 0, stream>>>(Y, E, a_w_out + (size_t)i * E * D, D, H, D, E);
            } else {
                const int j = i - NA;
                float* kvb = KV + (size_t)b * SEQ * 2 * KVD;
                if (i == NA) sgemm128<0><<<dim3(2 * KVD / 128, SEQ / 128), 256, 0, stream>>>(xb, D, kv_w, 2 * KVD, kvb, 2 * KVD, D);
                sgemm128<0><<<dim3(QD / 128, SEQ / 128), 256, 0, stream>>>(xb, D, b_w_q + (size_t)j * D * QD, QD, Y, QD, D);
                attn_naive<<<dim3(SEQ / 64, KVH), 64, 0, stream>>>(Y, kvb, BT, O);
                sgemm128<0><<<dim3(D / 128, SEQ / 128), 256, 0, stream>>>(O, KVD, b_w_o + (size_t)j * KVD * D, D, H, D, KVD);
            }
            ln_rows<<<SEQ, 256, 0, stream>>>(xb, D, ALPHA, H, D, ln_g + (size_t)(i * 2 + 0) * D, ln_b + (size_t)(i * 2 + 0) * D, xb, D, D);
            sgemm128<0><<<dim3(2 * FF / 128, SEQ / 128), 256, 0, stream>>>(xb, D, ffn_w_up + (size_t)i * D * 2 * FF, 2 * FF, RA, 2 * FF, D);
            convact_naive<<<dim3(FF / 256, SEQ), 256, 0, stream>>>(RA, ffn_conv_w + (size_t)i * 3 * 2 * FF, ffn_conv_b + (size_t)i * 2 * FF, Y);
            sgemm128<0><<<dim3(D / 128, SEQ / 128), 256, 0, stream>>>(Y, FF, ffn_w_down + (size_t)i * FF * D, D, H, D, FF);
            ln_rows<<<SEQ, 256, 0, stream>>>(xb, D, ALPHA, H, D, ln_g + (size_t)(i * 2 + 1) * D, ln_b + (size_t)(i * 2 + 1) * D, xb, D, D);
        }
    }
}
```
